# Optimizing an MI355X kernel written in HIP

```python
import math
import jax, jax.numpy as jnp
from jax import lax
import numpy as np

D_MODEL = 1024
BATCH = 8
SEQ = 4096
DEPTH = 4

CHUNK = 64
Q_BLOCK = 128
SPARSE_Q_BLOCK = 64
D_MIX = D_MODEL
D_A = D_MIX // 2
D_B = D_MIX - D_A
HEAD_DIM = 64
A_HEADS = D_A // HEAD_DIM
B_HEADS = D_B // (2 * HEAD_DIM)
B_VDIM = 2 * HEAD_DIM
IDX_HEADS = 4
IDX_DIM = 64
TOPK_MAX = 256
ROPE_THETA = 500000.0
ROT_DIM = HEAD_DIM // 4
EPS = 1e-6
D_PLE = 256
NEG_INF = -1e30
D_IN = 3 * D_A + IDX_HEADS * IDX_DIM + IDX_DIM + IDX_HEADS + D_A + 4 * D_B

kernel_name = "hybrid_dsa_diffattn_sandwich_ple"


def _rmsnorm(x, g):
    x32 = x.astype(jnp.float32)
    y = x32 * lax.rsqrt(jnp.mean(x32 * x32, axis=-1, keepdims=True) + EPS)
    return (y * g.astype(jnp.float32)).astype(x.dtype)


def _rope_tables(seq, dtype):
    pos = jnp.arange(seq, dtype=jnp.float32)
    inv = ROPE_THETA ** (-jnp.arange(0, ROT_DIM, 2, dtype=jnp.float32) / ROT_DIM)
    ang = pos[:, None] * inv[None, :]
    return jnp.cos(ang).astype(dtype), jnp.sin(ang).astype(dtype)


def _partial_rope(x, cos, sin):
    half = ROT_DIM // 2
    x1 = x[..., :half]
    x2 = x[..., half:ROT_DIM]
    c = cos[None, :, None, :]
    s = sin[None, :, None, :]
    return jnp.concatenate([x1 * c - x2 * s, x2 * c + x1 * s, x[..., ROT_DIM:]], axis=-1)


def _to_blocks(a, blk):
    b, s = a.shape[:2]
    return a.reshape((b, s // blk, blk) + a.shape[2:]).swapaxes(0, 1)


def _from_blocks(a):
    nb, b, blk = a.shape[:3]
    return a.swapaxes(0, 1).reshape((b, nb * blk) + a.shape[3:])


def _split_in(z):
    sizes = (D_A, D_A, D_A, IDX_HEADS * IDX_DIM, IDX_DIM, IDX_HEADS, D_A,
             B_HEADS * 2 * HEAD_DIM, B_HEADS * 2 * HEAD_DIM, B_HEADS * B_VDIM, D_B)
    offs = [int(o) for o in np.cumsum(sizes)[:-1]]
    return jnp.split(z, offs, axis=-1)


def _dsa_attention(q, k, v, qi, ki, wi, top_k):
    seq = q.shape[1]
    spos = jnp.arange(seq, dtype=jnp.int32)
    ki32 = ki.astype(jnp.float32)

    def block(args):
        qb, qib, wib, tpos = args
        limit = (tpos // CHUNK + 1) * CHUNK
        dots = jnp.einsum('bqhd,bsd->bqhs', qib.astype(jnp.float32), ki32) * (IDX_DIM ** -0.5)
        iscore = jnp.einsum('bqhs,bqh->bqs', jax.nn.relu(dots), wib.astype(jnp.float32))
        adm = spos[None, :] < limit[:, None]
        iscore = jnp.where(adm[None], iscore, -jnp.inf)
        _, idx = lax.top_k(iscore, top_k)
        valid = idx < limit[None, :, None]
        kg = jax.vmap(lambda kk, ii: kk[ii])(k, idx)
        vg = jax.vmap(lambda vv, ii: vv[ii])(v, idx)
        logits = jnp.einsum('bqhd,bqkhd->bhqk', qb, kg).astype(jnp.float32) * (HEAD_DIM ** -0.5)
        logits = jnp.where(valid[:, None], logits, NEG_INF)
        probs = jax.nn.softmax(logits, axis=-1).astype(v.dtype)
        return jnp.einsum('bhqk,bqkhd->bqhd', probs, vg)

    out = lax.map(block, (_to_blocks(q, SPARSE_Q_BLOCK), _to_blocks(qi, SPARSE_Q_BLOCK),
                          _to_blocks(wi, SPARSE_Q_BLOCK), spos.reshape(-1, SPARSE_Q_BLOCK)))
    out = _from_blocks(out)
    return out.reshape(out.shape[0], seq, -1)


def _diff_attention(q, k, v, lam, lam_init, sub_g):
    seq = q.shape[1]
    spos = jnp.arange(seq, dtype=jnp.int32)
    schunk = spos // CHUNK

    def block(args):
        qb, tpos = args
        allowed = schunk[None, :] <= (tpos // CHUNK)[:, None]
        logits = jnp.einsum('bqhcd,bshcd->bchqs', qb, k).astype(jnp.float32) * (HEAD_DIM ** -0.5)
        logits = jnp.where(allowed, logits, NEG_INF)
        probs = jax.nn.softmax(logits, axis=-1)
        attn = (probs[:, 0] - lam * probs[:, 1]).astype(v.dtype)
        return jnp.einsum('bhqs,bshe->bqhe', attn, v)

    out = _from_blocks(lax.map(block, (_to_blocks(q, Q_BLOCK), spos.reshape(-1, Q_BLOCK))))
    out = _rmsnorm(out, sub_g) * (1.0 - lam_init)
    return out.reshape(out.shape[0], seq, -1)


def setup_inputs(seed: int = 0) -> dict:
    key = jax.random.key(seed)
    ks = jax.random.split(key, 14)
    f32 = jnp.float32

    def nrm(k, shape, scale):
        return jax.random.normal(k, shape, f32) * scale

    return {
        "x": nrm(ks[0], (BATCH, SEQ, D_MODEL), 1.0),
        "p": nrm(ks[1], (DEPTH, BATCH, SEQ, D_PLE), 1.0),
        "pre_norm_g": 1.0 + nrm(ks[2], (DEPTH, D_MODEL), 0.02),
        "w_in": nrm(ks[3], (DEPTH, D_MODEL, D_IN), D_MODEL ** -0.5),
        "w_out": nrm(ks[4], (DEPTH, D_MIX, D_MODEL), D_MIX ** -0.5),
        "post_norm_g": 1.0 + nrm(ks[5], (DEPTH, D_MODEL), 0.02),
        "lambda_q1": nrm(ks[6], (DEPTH, HEAD_DIM), 0.1),
        "lambda_k1": nrm(ks[7], (DEPTH, HEAD_DIM), 0.1),
        "lambda_q2": nrm(ks[8], (DEPTH, HEAD_DIM), 0.1),
        "lambda_k2": nrm(ks[9], (DEPTH, HEAD_DIM), 0.1),
        "subln_g": 1.0 + nrm(ks[10], (DEPTH, B_VDIM), 0.02),
        "w_ple_gate": nrm(ks[11], (DEPTH, D_MODEL, D_MODEL), D_MODEL ** -0.5),
        "w_ple_proj": nrm(ks[12], (DEPTH, D_PLE, D_MODEL), D_PLE ** -0.5),
        "ple_norm_g": 1.0 + nrm(ks[13], (DEPTH, D_MODEL), 0.02),
    }


def reference(x, p, pre_norm_g, w_in, w_out, post_norm_g, lambda_q1, lambda_k1, lambda_q2,
              lambda_k2, subln_g, w_ple_gate, w_ple_proj, ple_norm_g):
    bsz, seq, _ = x.shape
    top_k = min(TOPK_MAX, seq // 4)
    cos, sin = _rope_tables(seq, x.dtype)
    for i in range(DEPTH):
        h = _rmsnorm(x, pre_norm_g[i])
        z = h @ w_in[i]
        qa, ka, va, qi, ki, wi, ga, qb, kb, vb, gb = _split_in(z)
        qa = _partial_rope(qa.reshape(bsz, seq, A_HEADS, HEAD_DIM), cos, sin)
        ka = _partial_rope(ka.reshape(bsz, seq, A_HEADS, HEAD_DIM), cos, sin)
        va = va.reshape(bsz, seq, A_HEADS, HEAD_DIM)
        qi = _partial_rope(qi.reshape(bsz, seq, IDX_HEADS, IDX_DIM), cos, sin)
        ki = _partial_rope(ki[:, :, None, :], cos, sin)[:, :, 0, :]
        wi = wi * (IDX_HEADS ** -0.5)
        oa = _dsa_attention(qa, ka, va, qi, ki, wi, top_k)
        qb = _partial_rope(qb.reshape(bsz, seq, B_HEADS * 2, HEAD_DIM), cos, sin).reshape(bsz, seq, B_HEADS, 2, HEAD_DIM)
        kb = _partial_rope(kb.reshape(bsz, seq, B_HEADS * 2, HEAD_DIM), cos, sin).reshape(bsz, seq, B_HEADS, 2, HEAD_DIM)
        vb = vb.reshape(bsz, seq, B_HEADS, B_VDIM)
        lam_init = 0.8 - 0.6 * math.exp(-0.3 * i)
        lam = (jnp.exp(jnp.sum(lambda_q1[i].astype(jnp.float32) * lambda_k1[i].astype(jnp.float32)))
               - jnp.exp(jnp.sum(lambda_q2[i].astype(jnp.float32) * lambda_k2[i].astype(jnp.float32)))
               + lam_init)
        ob = _diff_attention(qb, kb, vb, lam, lam_init, subln_g[i])
        y = jnp.concatenate([oa * jax.nn.silu(ga), ob * jax.nn.silu(gb)], axis=-1) @ w_out[i]
        x = x + _rmsnorm(y, post_norm_g[i])
        gate = jax.nn.sigmoid(x @ w_ple_gate[i])
        e = (p[i] @ w_ple_proj[i]) * gate
        x = x + _rmsnorm(e, ple_norm_g[i])
    return x
```

```cpp
#include <hip/hip_runtime.h>
#include <cstdio>
#include <cstdint>

#ifndef MK_PER_PHASE
#define MK_PER_PHASE 0
#endif

constexpr int NB = 8, S = 4096, DM = 1024, M = NB * S, DEPTH = 4, DPLE = 256;
constexpr int ZP = 4608;
constexpr int C_QA = 0, C_KA = 512, C_VA = 1024, C_QB = 1536, C_KB = 2048, C_VB = 2560, C_GA = 3072, C_GB = 3584, C_QI = 4096, C_KI = 4352, C_WI = 4416;
constexpr int DIN = 4420;
constexpr float EPS = 1e-6f;

__device__ __forceinline__ int ltid() { int t = threadIdx.x; asm volatile("" : "+v"(t)); return t; }

namespace pg8 {
#define PG8_LAS __attribute__((address_space(3)))
typedef unsigned short bf16_t;
typedef short bf16x8 __attribute__((ext_vector_type(8)));
typedef float f32x4 __attribute__((ext_vector_type(4)));
typedef unsigned u32x4 __attribute__((ext_vector_type(4)));
constexpr int BM = 256, BK = 64, HALF = 128, HTB = HALF * BK * 2, STAGE_BYTES = 8 * HTB, NXCD = 8, WGM = 8;

__host__ __device__ __forceinline__ int lds_byte(int r, int c) { const int st = (r >> 4) * 2 + (c >> 5), rr = r & 15, cc = c & 31, ob = rr * 64 + cc * 2; return st * 1024 + (ob ^ (((ob >> 9) & 1) << 5)); }
__host__ __device__ __forceinline__ void stage_rc(int b, int& R, int& C) { const int st = b / 1024, sb = b % 1024, swz = sb ^ (((sb >> 9) & 1) << 5); R = (st >> 1) * 16 + swz / 64; C = (st & 1) * 32 + (swz % 64) / 2; }
__host__ __device__ __forceinline__ int perm32(int rho) { const int n = rho >> 4, i = rho & 15; return 8 * (i >> 2) + 4 * n + (i & 3); }

struct Unit { int pm, pn; };
struct Gemm { const bf16_t* A; const bf16_t* Bt; int M, N, K; };

struct StaticOrder {
    int nM, nN, nwg, G, c;
    __host__ __device__ void init(int M_, int N_, int G_, int c_) { nM = M_ / BM; nN = N_ / BM; nwg = nM * nN; G = G_; c = c_; }
    __host__ __device__ bool next(int i, Unit& u) const {
        const long L = (long)i * G + c; if (L >= nwg) return false;
        int wgid = (int)L; { const int q = nwg / NXCD, r = nwg % NXCD, xcd = wgid % NXCD, off = wgid / NXCD; wgid = (xcd < r ? xcd * (q + 1) : r * (q + 1) + (xcd - r) * q) + off; }
        const int nig = WGM * nN, gid = wgid / nig, fm = gid * WGM, gsz = (nM - fm) < WGM ? (nM - fm) : WGM;
        u.pm = fm + ((wgid % nig) % gsz); u.pn = (wgid % nig) / gsz; return true;
    }
    __device__ __forceinline__ void a_ready(const Unit&) const {}
    __device__ __forceinline__ void done(const Unit&) const {}
};

__device__ __forceinline__ unsigned cvt_pk_bf16(float lo, float hi) { unsigned r; asm volatile("v_cvt_pk_bf16_f32 %0, %1, %2" : "=v"(r) : "v"(lo), "v"(hi)); return r; }
__device__ __forceinline__ float bf_lo(unsigned w) { return __uint_as_float(w << 16); }
__device__ __forceinline__ float bf_hi(unsigned w) { return __uint_as_float(w & 0xffff0000u); }

struct EpiStore {
    static constexpr bool PERM = true, AFTER_DRAIN = false;
    bf16_t* O; int ldc;
    __device__ __forceinline__ void operator()(const f32x4 (&acc)[2][2][4][2], const Unit& u, int wr, int wc, int fr, int fq) const {
        const int row0 = u.pm * BM + wr * 64 + fr; const int col0 = u.pn * BM + wc * 32 + 8 * fq;
#pragma unroll
        for (int ai = 0; ai < 2; ++ai)
#pragma unroll
            for (int m = 0; m < 4; ++m) { bf16_t* rowp = O + (size_t)(row0 + ai * HALF + m * 16) * ldc + col0;
#pragma unroll
                for (int bj = 0; bj < 2; ++bj) { const f32x4 v0 = acc[ai][bj][m][0], v1 = acc[ai][bj][m][1];
                    u32x4 w; w.x = cvt_pk_bf16(v0[0], v0[1]); w.y = cvt_pk_bf16(v0[2], v0[3]); w.z = cvt_pk_bf16(v1[0], v1[1]); w.w = cvt_pk_bf16(v1[2], v1[3]);
                    *(u32x4*)(rowp + bj * HALF) = w; } }
    }
};
struct EpiGate {
    static constexpr bool PERM = true, AFTER_DRAIN = false;
    bf16_t* O; const bf16_t* PE; int ldc;
    __device__ __forceinline__ void operator()(const f32x4 (&acc)[2][2][4][2], const Unit& u, int wr, int wc, int fr, int fq) const {
        const int row0 = u.pm * BM + wr * 64 + fr; const int col0 = u.pn * BM + wc * 32 + 8 * fq;
#pragma unroll
        for (int ai = 0; ai < 2; ++ai)
#pragma unroll
            for (int m = 0; m < 4; ++m) { const size_t off = (size_t)(row0 + ai * HALF + m * 16) * ldc + col0;
#pragma unroll
                for (int bj = 0; bj < 2; ++bj) { const f32x4 v0 = acc[ai][bj][m][0], v1 = acc[ai][bj][m][1];
                    const u32x4 pe = *(const u32x4*)(PE + off + bj * HALF);
                    float g[8] = {v0[0], v0[1], v0[2], v0[3], v1[0], v1[1], v1[2], v1[3]};
                    float p[8] = {bf_lo(pe.x), bf_hi(pe.x), bf_lo(pe.y), bf_hi(pe.y), bf_lo(pe.z), bf_hi(pe.z), bf_lo(pe.w), bf_hi(pe.w)};
                    float e[8];
#pragma unroll
                    for (int i = 0; i < 8; ++i) { const float sg = __builtin_amdgcn_rcpf(1.0f + __builtin_amdgcn_exp2f(-1.4426950408889634f * g[i])); e[i] = p[i] * sg; }
                    u32x4 w; w.x = cvt_pk_bf16(e[0], e[1]); w.y = cvt_pk_bf16(e[2], e[3]); w.z = cvt_pk_bf16(e[4], e[5]); w.w = cvt_pk_bf16(e[6], e[7]);
                    *(u32x4*)(O + off + bj * HALF) = w; } }
    }
};
struct EpiZ {
    static constexpr bool PERM = true, AFTER_DRAIN = false;
    bf16_t* Z; const float* rstd; const float* cs;
    __device__ __forceinline__ void operator()(const f32x4 (&acc)[2][2][4][2], const Unit& u, int wr, int wc, int fr, int fq) const {
        const int row0 = u.pm * BM + wr * 64 + fr; const int col0 = u.pn * BM + wc * 32 + 8 * fq;
        const int pn = u.pn;
        const bool rope_tile = (pn < 4) || (pn >= 6 && pn < 10) || (pn == 16) || (pn == 17);
        const bool rope_lane = ((wc & 1) == 0) && (fq < 2);
#pragma unroll
        for (int ai = 0; ai < 2; ++ai)
#pragma unroll
            for (int m = 0; m < 4; ++m) { const int row = row0 + ai * HALF + m * 16; const float rs = rstd[row]; bf16_t* rowp = Z + (size_t)row * ZP + col0;
                f32x4 c0 = {1.f, 1.f, 1.f, 1.f}, c1 = c0, s0 = {0.f, 0.f, 0.f, 0.f}, s1 = s0;
                if (rope_tile && rope_lane) { const float* cp = cs + (size_t)(row & (S - 1)) * 16; c0 = *(const f32x4*)cp; c1 = *(const f32x4*)(cp + 4); s0 = *(const f32x4*)(cp + 8); s1 = *(const f32x4*)(cp + 12);
                    if (fq == 0) { s0 = -s0; s1 = -s1; } }
#pragma unroll
                for (int bj = 0; bj < 2; ++bj) { f32x4 v0 = acc[ai][bj][m][0] * rs, v1 = acc[ai][bj][m][1] * rs;
                    if (rope_tile) {
                        f32x4 p0, p1;
#pragma unroll
                        for (int i = 0; i < 4; ++i) { p0[i] = __shfl_xor(v0[i], 16); p1[i] = __shfl_xor(v1[i], 16); }
                        const bool on = rope_lane && (pn != 17 || (bj == 0 && wc < 2));
                        if (on) { v0 = v0 * c0 + p0 * s0; v1 = v1 * c1 + p1 * s1; }
                    }
                    u32x4 w; w.x = cvt_pk_bf16(v0[0], v0[1]); w.y = cvt_pk_bf16(v0[2], v0[3]); w.z = cvt_pk_bf16(v1[0], v1[1]); w.w = cvt_pk_bf16(v1[2], v1[3]);
                    *(u32x4*)(rowp + bj * HALF) = w; } }
    }
};

template <class Epi, class Sched, bool ALIGN_EPI = false, bool SP2 = false>
__device__ __forceinline__ void gemm_phase(PG8_LAS unsigned char* lds, const Gemm g, const Sched& S, const Epi& E) {
    const int tid = ltid(), wid = __builtin_amdgcn_readfirstlane(tid >> 6), lane = tid & 63, wr = wid >> 2, wc = wid & 3, fr = lane & 15, fq = lane >> 4;
    const int K = g.K, nt = K / BK;
    unsigned voffA[2], voffB[2];
#pragma unroll
    for (int i = 0; i < 2; ++i) { int R, C; stage_rc(tid * 16 + i * 8192, R, C); const int Rb = Epi::PERM ? ((R & ~31) + perm32(R & 31)) : R;
        voffA[i] = (unsigned)(R * K + C) * 2u; voffB[i] = (unsigned)(Rb * K + C) * 2u; }
    const size_t kstep = (size_t)(BK * 2);
    const size_t hstep = (size_t)HALF * K * 2;
    const size_t tstep = 2 * hstep;
    const unsigned ldsw = (unsigned)wid * 1024u;
    const int aoff = lds_byte(wr * 64 + fr, fq * 8), boff = lds_byte(wc * 32 + fr, fq * 8);
#define PG8_SA(b, h) (((b) * 2 + (h)) * HTB)
#define PG8_SB(b, h) ((4 + (b) * 2 + (h)) * HTB)
#define PG8_STAGE(bufoff, gbase, voff) do { _Pragma("unroll") for (int _i = 0; _i < 2; ++_i) \
        __builtin_amdgcn_global_load_lds((const unsigned*)((const char*)(gbase) + (voff)[_i]), (PG8_LAS unsigned*)(lds + (bufoff) + ldsw + _i * 8192), 16, 0, 0); } while (0)
#define PG8_LDA(dst, b, h) do { _Pragma("unroll") for (int m = 0; m < 4; ++m) _Pragma("unroll") for (int k = 0; k < 2; ++k) dst[m][k] = *(const PG8_LAS bf16x8*)(lds + PG8_SA(b, h) + aoff + m * 2048 + k * 1024); } while (0)
#define PG8_LDB(dst, b, h) do { _Pragma("unroll") for (int n = 0; n < 2; ++n) _Pragma("unroll") for (int k = 0; k < 2; ++k) dst[n][k] = *(const PG8_LAS bf16x8*)(lds + PG8_SB(b, h) + boff + n * 2048 + k * 1024); } while (0)
#define PG8_MMA(ai, bj, At, Bt) do { __builtin_amdgcn_s_setprio(1); _Pragma("unroll") for (int m = 0; m < 4; ++m) _Pragma("unroll") for (int n = 0; n < 2; ++n) _Pragma("unroll") for (int k = 0; k < 2; ++k) \
        acc[ai][bj][m][n] = __builtin_amdgcn_mfma_f32_16x16x32_bf16(Bt[n][k], At[m][k], acc[ai][bj][m][n], 0, 0, 0); __builtin_amdgcn_s_setprio(0); } while (0)
#define PG8_WAIT_V(n) asm volatile("s_waitcnt vmcnt(" #n ")" ::: "memory")
#define PG8_WAIT_L(n) asm volatile("s_waitcnt lgkmcnt(" #n ")" ::: "memory")
#define PG8_BAR __builtin_amdgcn_s_barrier()
#define PG8_SCHED __builtin_amdgcn_sched_barrier(0)
    Unit cur, nxt; int ui = 0;
    if (!S.next(0, cur)) return;
    f32x4 acc[2][2][4][2];
#pragma unroll
    for (int a = 0; a < 2; ++a)
#pragma unroll
        for (int b = 0; b < 2; ++b)
#pragma unroll
            for (int m = 0; m < 4; ++m)
#pragma unroll
                for (int n = 0; n < 2; ++n) acc[a][b][m][n] = (f32x4){0.f, 0.f, 0.f, 0.f};
    bf16x8 At[4][2], B0[2][2], B1[2][2];
    const char* cA = (const char*)g.A + (size_t)cur.pm * tstep; const char* cB = (const char*)g.Bt + (size_t)cur.pn * tstep;
    S.a_ready(cur);
    if constexpr (SP2) {
        PG8_STAGE(PG8_SB(0, 0), cB, voffB); PG8_STAGE(PG8_SB(0, 1), cB + hstep, voffB); PG8_STAGE(PG8_SA(0, 0), cA, voffA); PG8_STAGE(PG8_SA(0, 1), cA + hstep, voffA);
        if (wr == 1) PG8_BAR;
        PG8_WAIT_V(2); PG8_BAR;
        PG8_STAGE(PG8_SB(1, 0), cB + kstep, voffB); PG8_STAGE(PG8_SA(1, 0), cA + kstep, voffA); PG8_STAGE(PG8_SB(1, 1), cB + hstep + kstep, voffB);
        PG8_WAIT_V(6); PG8_BAR;
    } else {
        PG8_STAGE(PG8_SB(0, 0), cB, voffB); PG8_STAGE(PG8_SA(0, 0), cA, voffA); PG8_STAGE(PG8_SB(0, 1), cB + hstep, voffB); PG8_STAGE(PG8_SA(0, 1), cA + hstep, voffA);
        if (wr == 1) PG8_BAR;
        PG8_WAIT_V(4); PG8_BAR;
        PG8_STAGE(PG8_SB(1, 0), cB + kstep, voffB); PG8_STAGE(PG8_SA(1, 0), cA + kstep, voffA); PG8_STAGE(PG8_SB(1, 1), cB + hstep + kstep, voffB);
        PG8_WAIT_V(6); PG8_BAR;
    }
    for (;;) {
        const bool has_next = S.next(ui + 1, nxt);
        const char* nA = has_next ? (const char*)g.A + (size_t)nxt.pm * tstep : cA; const char* nB = has_next ? (const char*)g.Bt + (size_t)nxt.pn * tstep : cB;
        for (int t = 0; t < nt; t += 2) {
            const bool last = (t == nt - 2);
            const char* a1 = cA + (size_t)(t + 1) * kstep;
            const char* a2 = last ? nA : cA + (size_t)(t + 2) * kstep; const char* b2 = last ? nB : cB + (size_t)(t + 2) * kstep;
            const char* a3 = a2 + kstep; const char* b3 = b2 + kstep;
            if (last && has_next) S.a_ready(nxt);
            if constexpr (SP2) {
            PG8_LDB(B0, 0, 0); PG8_LDB(B1, 0, 1); PG8_SCHED; PG8_LDA(At, 0, 0); PG8_STAGE(PG8_SA(1, 1), a1 + hstep, voffA);
            PG8_WAIT_V(8); PG8_WAIT_L(0); PG8_BAR; PG8_MMA(0, 0, At, B0); PG8_MMA(0, 1, At, B1); PG8_BAR; PG8_SCHED;
            PG8_LDA(At, 0, 1); PG8_STAGE(PG8_SB(0, 0), b2, voffB); PG8_STAGE(PG8_SB(0, 1), b2 + hstep, voffB); PG8_STAGE(PG8_SA(0, 0), a2, voffA);
            PG8_WAIT_V(8); PG8_WAIT_L(0); PG8_BAR; PG8_MMA(1, 0, At, B0); PG8_MMA(1, 1, At, B1); PG8_BAR; PG8_SCHED;
            PG8_LDB(B0, 1, 0); PG8_LDB(B1, 1, 1); PG8_SCHED; PG8_LDA(At, 1, 0); PG8_STAGE(PG8_SA(0, 1), a2 + hstep, voffA);
            PG8_WAIT_V(8); PG8_WAIT_L(0); PG8_BAR; PG8_MMA(0, 0, At, B0); PG8_MMA(0, 1, At, B1); PG8_BAR; PG8_SCHED;
            PG8_LDA(At, 1, 1); PG8_STAGE(PG8_SB(1, 0), b3, voffB); PG8_STAGE(PG8_SB(1, 1), b3 + hstep, voffB); PG8_STAGE(PG8_SA(1, 0), a3, voffA);
            PG8_WAIT_V(8); PG8_WAIT_L(0); PG8_BAR; PG8_MMA(1, 0, At, B0); PG8_MMA(1, 1, At, B1); PG8_BAR; PG8_SCHED;
            } else {
            PG8_LDB(B0, 0, 0); PG8_SCHED; PG8_LDA(At, 0, 0); PG8_STAGE(PG8_SA(1, 1), a1 + hstep, voffA);
            PG8_WAIT_L(8); PG8_BAR; PG8_WAIT_L(0); PG8_MMA(0, 0, At, B0); PG8_BAR; PG8_SCHED;
            PG8_LDB(B1, 0, 1); PG8_STAGE(PG8_SB(0, 0), b2, voffB);
            PG8_BAR; PG8_WAIT_L(0); PG8_MMA(0, 1, At, B1); PG8_BAR;
            PG8_LDA(At, 0, 1); PG8_STAGE(PG8_SA(0, 0), a2, voffA);
            PG8_BAR; PG8_WAIT_L(0); PG8_MMA(1, 0, At, B0); PG8_BAR; PG8_SCHED;
            PG8_STAGE(PG8_SB(0, 1), b2 + hstep, voffB);
            PG8_WAIT_V(6); PG8_BAR; PG8_MMA(1, 1, At, B1); PG8_BAR;
            PG8_LDB(B0, 1, 0); PG8_SCHED; PG8_LDA(At, 1, 0); PG8_STAGE(PG8_SA(0, 1), a2 + hstep, voffA);
            PG8_WAIT_L(8); PG8_BAR; PG8_WAIT_L(0); PG8_MMA(0, 0, At, B0); PG8_BAR; PG8_SCHED;
            PG8_LDB(B1, 1, 1); PG8_STAGE(PG8_SB(1, 0), b3, voffB);
            PG8_BAR; PG8_WAIT_L(0); PG8_MMA(0, 1, At, B1); PG8_BAR;
            PG8_LDA(At, 1, 1); PG8_STAGE(PG8_SA(1, 0), a3, voffA);
            PG8_BAR; PG8_WAIT_L(0); PG8_MMA(1, 0, At, B0); PG8_BAR; PG8_SCHED;
            PG8_STAGE(PG8_SB(1, 1), b3 + hstep, voffB);
            PG8_WAIT_V(6); PG8_BAR; PG8_MMA(1, 1, At, B1); PG8_BAR;
            }
        }
        if constexpr (ALIGN_EPI) { if (wr == 0) PG8_BAR; }
        if constexpr (!Epi::AFTER_DRAIN) { E(acc, cur, wr, wc, fr, fq); S.done(cur); }
        if (!has_next) break;
#pragma unroll
        for (int a = 0; a < 2; ++a)
#pragma unroll
            for (int b = 0; b < 2; ++b)
#pragma unroll
                for (int m = 0; m < 4; ++m)
#pragma unroll
                    for (int n = 0; n < 2; ++n) acc[a][b][m][n] = (f32x4){0.f, 0.f, 0.f, 0.f};
        cur = nxt; cA = nA; cB = nB; ++ui;
        if constexpr (ALIGN_EPI) { if (wr == 1) PG8_BAR; }
    }
    PG8_WAIT_V(0);
    if constexpr (!ALIGN_EPI) { if (wr == 0) PG8_BAR; }
    PG8_BAR;
#undef PG8_SA
#undef PG8_SB
#undef PG8_STAGE
#undef PG8_LDA
#undef PG8_LDB
#undef PG8_MMA
#undef PG8_WAIT_V
#undef PG8_WAIT_L
#undef PG8_BAR
#undef PG8_SCHED
}
}

typedef pg8::bf16_t bf16_t;
#define GAS __attribute__((address_space(1)))
#define LAS __attribute__((address_space(3)))
typedef unsigned v4u __attribute__((ext_vector_type(4)));
typedef unsigned v2u __attribute__((ext_vector_type(2)));
typedef float f32x4 __attribute__((ext_vector_type(4)));
typedef float f32x2 __attribute__((ext_vector_type(2)));
#define RLX_AGENT __ATOMIC_RELAXED, __HIP_MEMORY_SCOPE_AGENT
using pg8::cvt_pk_bf16; using pg8::bf_lo; using pg8::bf_hi;

namespace att {
using bf16x8 = __attribute__((ext_vector_type(8))) short;
using s16x4  = __attribute__((ext_vector_type(4))) short;
using f32x16 = __attribute__((ext_vector_type(16))) float;
using u32x4  = __attribute__((ext_vector_type(4))) unsigned;
constexpr int KVBLK = 64;
constexpr float SCALE = 0.125f;
constexpr float THR = 8.f;
constexpr int SHM_T = KVBLK * 128 * 2;
constexpr int LDS_V = 0, LDS_K = 2 * SHM_T, LDS_WS = 4 * SHM_T, LDS_BYTES = LDS_WS + 8 * 64 * 4;
#define KSWZ(row, colB) ((row) * 256 + ((colB) ^ (((row) & 7) << 4)))
#define SBAR() __builtin_amdgcn_sched_barrier(0)
__device__ __forceinline__ int crow(int r, int hi) { return (r & 3) + 8 * (r >> 2) + 4 * hi; }

__device__ __forceinline__ void partialSM(f32x16& p0, f32x16& p1, float& m_reg, float& mn, float& alpha) {
  constexpr float C = SCALE * 1.4426950408889634f;
  float pmax = p0[0];
#pragma unroll
  for (int r = 1; r < 16; ++r) pmax = fmaxf(pmax, p0[r]);
#pragma unroll
  for (int r = 0; r < 16; ++r) pmax = fmaxf(pmax, p1[r]);
  { auto rr = __builtin_amdgcn_permlane32_swap(__float_as_uint(pmax), __float_as_uint(pmax), false, false);
    pmax = fmaxf(__uint_as_float(rr[0]), __uint_as_float(rr[1])); }
  if (__builtin_expect(__all(pmax - m_reg <= THR / SCALE), 1)) { mn = m_reg; alpha = 1.f; }
  else { mn = fmaxf(m_reg, pmax); alpha = __builtin_amdgcn_exp2f((m_reg - mn) * C); m_reg = mn; }
  const float mnC = -mn * C;
#pragma unroll
  for (int r = 0; r < 16; ++r) p0[r] = fmaf(p0[r], C, mnC);
#pragma unroll
  for (int r = 0; r < 16; ++r) p1[r] = fmaf(p1[r], C, mnC);
#pragma unroll
  for (int r = 0; r < 16; ++r) p0[r] = __builtin_amdgcn_exp2f(p0[r]);
}
__device__ __forceinline__ void finishSM(f32x16& p0, f32x16& p1, float alpha, float& l_reg, bf16x8& pa0, bf16x8& pa1, bf16x8& pa2, bf16x8& pa3) {
#pragma unroll
  for (int r = 0; r < 16; ++r) p1[r] = __builtin_amdgcn_exp2f(p1[r]);
  float ps = 0;
#pragma unroll
  for (int r = 0; r < 16; ++r) ps += p0[r];
#pragma unroll
  for (int r = 0; r < 16; ++r) ps += p1[r];
  { auto rr = __builtin_amdgcn_permlane32_swap(__float_as_uint(ps), __float_as_uint(ps), false, false);
    ps = __uint_as_float(rr[0]) + __uint_as_float(rr[1]); }
  l_reg = l_reg * alpha + ps;
#define PK4(P, BASE, OUT) do { unsigned a0 = cvt_pk_bf16(P[BASE + 0], P[BASE + 1]), a1 = cvt_pk_bf16(P[BASE + 2], P[BASE + 3]);   \
    unsigned b0 = cvt_pk_bf16(P[BASE + 4], P[BASE + 5]), b1 = cvt_pk_bf16(P[BASE + 6], P[BASE + 7]);                              \
    auto r0 = __builtin_amdgcn_permlane32_swap(a0, b0, false, false); auto r1 = __builtin_amdgcn_permlane32_swap(a1, b1, false, false); \
    u32x4 w = {r0[0], r1[0], r0[1], r1[1]}; OUT = *reinterpret_cast<bf16x8*>(&w); } while (0)
  PK4(p0, 0, pa0); PK4(p0, 8, pa1); PK4(p1, 0, pa2); PK4(p1, 8, pa3);
#undef PK4
}
__device__ __forceinline__ void qkt(f32x16& p0, f32x16& p1, const char* Ks, const bf16x8* qr, int r32, int hi, int cbase) {
  p0 = f32x16{}; p1 = f32x16{};
#pragma unroll
  for (int dd = 0; dd < 4; ++dd) { const int cb = cbase + (dd * 16 + hi * 8) * 2;
    const bf16x8 b0 = *reinterpret_cast<const bf16x8*>(Ks + KSWZ(r32, cb));
    const bf16x8 b1 = *reinterpret_cast<const bf16x8*>(Ks + KSWZ(32 + r32, cb));
    p0 = __builtin_amdgcn_mfma_f32_32x32x16_bf16(b0, qr[dd], p0, 0, 0, 0);
    p1 = __builtin_amdgcn_mfma_f32_32x32x16_bf16(b1, qr[dd], p1, 0, 0, 0); }
}
__device__ __forceinline__ int v_st(int k, int c) { const int kk = (k & ~0xC) | ((k & 4) << 1) | ((k & 8) >> 1); return ((kk >> 3) * 4 + (c >> 5)) * 512 + ((kk & 7) * 32 + (c & 31)) * 2; }
__device__ __forceinline__ int v_rd_base(int lane) { return ((lane & 3) << 3) | (((lane >> 2) & 3) << 6) | (((lane >> 4) & 1) << 5) | (((lane >> 5) & 1) << 8); }
constexpr int v_rd_off(int d0, int ks, int half) { return d0 * 512 + ks * 4096 + half * 2048; }
template <int OFF> __device__ __forceinline__ s16x4 tr_read(int vb) {
  s16x4 r; asm volatile("ds_read_b64_tr_b16 %0, %1 offset:%2" : "=&v"(r) : "v"(vb), "i"(OFF) : "memory"); return r;
}
template <int D0> __device__ __forceinline__ void pv_one(f32x16& od, int vb, bf16x8 pa0, bf16x8 pa1, bf16x8 pa2, bf16x8 pa3) {
  const s16x4 l0 = tr_read<v_rd_off(D0, 0, 0)>(vb), h0 = tr_read<v_rd_off(D0, 0, 1)>(vb), l1 = tr_read<v_rd_off(D0, 1, 0)>(vb), h1 = tr_read<v_rd_off(D0, 1, 1)>(vb);
  const s16x4 l2 = tr_read<v_rd_off(D0, 2, 0)>(vb), h2 = tr_read<v_rd_off(D0, 2, 1)>(vb), l3 = tr_read<v_rd_off(D0, 3, 0)>(vb), h3 = tr_read<v_rd_off(D0, 3, 1)>(vb);
  asm volatile("s_waitcnt lgkmcnt(0)" ::: "memory"); SBAR();
#define PK(L, H) (bf16x8){L[0], L[1], L[2], L[3], H[0], H[1], H[2], H[3]}
  od = __builtin_amdgcn_mfma_f32_32x32x16_bf16(pa0, PK(l0, h0), od, 0, 0, 0);
  od = __builtin_amdgcn_mfma_f32_32x32x16_bf16(pa1, PK(l1, h1), od, 0, 0, 0);
  od = __builtin_amdgcn_mfma_f32_32x32x16_bf16(pa2, PK(l2, h2), od, 0, 0, 0);
  od = __builtin_amdgcn_mfma_f32_32x32x16_bf16(pa3, PK(l3, h3), od, 0, 0, 0);
#undef PK
}
template <int ND> __device__ __forceinline__ void pv_all(f32x16* o, int vb, bf16x8 pa0, bf16x8 pa1, bf16x8 pa2, bf16x8 pa3) {
  pv_one<0>(o[0], vb, pa0, pa1, pa2, pa3); pv_one<1>(o[1], vb, pa0, pa1, pa2, pa3);
  if constexpr (ND == 4) { pv_one<2>(o[2], vb, pa0, pa1, pa2, pa3); pv_one<3>(o[3], vb, pa0, pa1, pa2, pa3); }
}
__device__ __forceinline__ void apply_mask(f32x16& p0, f32x16& p1, v2u mw, int hi) {
  const unsigned w0 = mw.x >> (4 * hi), w1 = mw.y >> (4 * hi);
#pragma unroll
  for (int r = 0; r < 16; ++r) { const int bit = (r & 3) + 8 * (r >> 2);
    p0[r] = ((w0 >> bit) & 1u) ? p0[r] : -INFINITY; p1[r] = ((w1 >> bit) & 1u) ? p1[r] : -INFINITY; }
}
__device__ __forceinline__ void kill_tile(f32x16& p0, f32x16& p1) {
#pragma unroll
  for (int r = 0; r < 16; ++r) { p0[r] = -INFINITY; p1[r] = -INFINITY; }
}
__device__ __forceinline__ float wave_sum(float v) {
#pragma unroll
  for (int o = 1; o < 64; o <<= 1) v += __shfl_xor(v, o);
  return v;
}
__device__ __forceinline__ float silu(float g) { return g * __builtin_amdgcn_rcpf(1.0f + __builtin_amdgcn_exp2f(-1.4426950408889634f * g)); }

template <int MODE>
__device__ __forceinline__ void attn_unit(const bf16_t* __restrict__ Z, const unsigned* __restrict__ mask, bf16_t* __restrict__ AO, int b, int hp, int qb, char* lds,
                                          float lam, const float* __restrict__ subg, float oml) {
  constexpr int ND = MODE ? 4 : 2;
  constexpr int QC = MODE ? C_QB : C_QA, KC = MODE ? C_KB : C_KA, VC = MODE ? C_VB : C_VA, GC = MODE ? C_GB : C_GA;
  const int tid = ltid(), wid = __builtin_amdgcn_readfirstlane(tid >> 6), lane = tid & 63, r32 = lane & 31, hi = lane >> 5;
  const int c = wid >> 2, qs = wid & 3;
  const size_t rowb = (size_t)b * S;
  const bf16_t* Kh = Z + rowb * ZP + KC + hp * 128;
  const bf16_t* Vh = Z + rowb * ZP + VC + hp * 128;
  char* V_lds = lds + LDS_V; char* K_lds = lds + LDS_K;
  float* ws = (float*)(lds + LDS_WS) + wid * 64; float* li_l = ws; float* al_l = ws + 32;
  float m_reg = -1e30f, l_reg = 0; f32x16 o[ND]; bf16x8 qr[4];
#pragma unroll
  for (int d = 0; d < ND; ++d) o[d] = f32x16{};
  const int tq = qb * 128 + qs * 32 + r32;
  { const bf16_t* Qw = Z + (rowb + tq) * ZP + QC + hp * 128 + c * 64 + hi * 8;
#pragma unroll
    for (int dd = 0; dd < 4; ++dd) qr[dd] = *reinterpret_cast<const bf16x8*>(Qw + dd * 16); }
  const int cbase = c * 128;
  const int sr = tid >> 4, sc = (tid & 15) * 8, vst0 = v_st(sr, sc), vst1 = v_st(32 + sr, sc);
  const int vb0 = (int)(uintptr_t)V_lds + v_rd_base(lane) + (MODE ? 0 : c * 1024);
  struct { bf16x8 vs0, vs1, ks0, ks1; } sr_[2];
#define SLOAD(i, k0) do { sr_[i].vs0 = *reinterpret_cast<const bf16x8*>(&Vh[(size_t)((k0) + sr) * ZP + sc]); sr_[i].vs1 = *reinterpret_cast<const bf16x8*>(&Vh[(size_t)((k0) + 32 + sr) * ZP + sc]); \
    sr_[i].ks0 = *reinterpret_cast<const bf16x8*>(&Kh[(size_t)((k0) + sr) * ZP + sc]); sr_[i].ks1 = *reinterpret_cast<const bf16x8*>(&Kh[(size_t)((k0) + 32 + sr) * ZP + sc]); } while (0)
#define SWRITE(bb, i) do { *(bf16x8*)(V_lds + (bb) * SHM_T + vst0) = sr_[i].vs0;          \
    *(bf16x8*)(V_lds + (bb) * SHM_T + vst1) = sr_[i].vs1; const int kc = sc * 2;               \
    *(bf16x8*)(K_lds + (bb) * SHM_T + KSWZ(sr, kc)) = sr_[i].ks0;                       \
    *(bf16x8*)(K_lds + (bb) * SHM_T + KSWZ(32 + sr, kc)) = sr_[i].ks1; } while (0)
#define SWAIT() asm volatile("s_waitcnt vmcnt(4)" ::: "memory")
#define RESC(a) do { if (__any((a) < 1.f)) { if (hi == 0) al_l[r32] = (a); asm volatile("s_waitcnt lgkmcnt(0)" ::: "memory"); \
    _Pragma("unroll") for (int d = 0; d < ND; ++d) _Pragma("unroll") for (int r = 0; r < 16; ++r) o[d][r] *= al_l[crow(r, hi)]; } } while (0)
  f32x16 pA0, pA1, pB0, pB1; float mnA, mnB, alA, alB; bf16x8 pa0, pa1, pa2, pa3;
  const int NT = 2 * qb + 2;
  const bool lastdead = (qs < 2);
  const unsigned* mrow = mask + (rowb + tq) * 128;
  v2u mwa = {0u, 0u}, mwb = {0u, 0u};
#define MLOAD(j) (*reinterpret_cast<const v2u*>(mrow + 2 * (j)))
  constexpr int SE = 0, SO = 1;
  if constexpr (MODE == 0) { mwa = MLOAD(0); }
  SLOAD(SE, 0); asm volatile("s_waitcnt vmcnt(0)" ::: "memory"); SWRITE(0, SE); __syncthreads();
  qkt(pA0, pA1, K_lds, qr, r32, hi, cbase);
  if constexpr (MODE == 0) { apply_mask(pA0, pA1, mwa, hi); if (2 < NT) mwa = MLOAD(2); mwb = MLOAD(1); }
  partialSM(pA0, pA1, m_reg, mnA, alA);
  SLOAD(SO, KVBLK); if (2 < NT) SLOAD(SE, 2 * KVBLK);
  SWAIT(); SWRITE(1, SO); __syncthreads();
  for (int j = 1; j + 1 < NT; j += 2) {
    SBAR(); qkt(pB0, pB1, K_lds + SHM_T, qr, r32, hi, cbase);
    if constexpr (MODE == 0) { apply_mask(pB0, pB1, mwb, hi); mwb = MLOAD(j + 2); }
    finishSM(pA0, pA1, alA, l_reg, pa0, pa1, pa2, pa3); SBAR();
    SLOAD(SO, (j + 2) * KVBLK); SBAR();
    pv_all<ND>(o, vb0, pa0, pa1, pa2, pa3); partialSM(pB0, pB1, m_reg, mnB, alB);
    __syncthreads(); SWAIT(); SWRITE(0, SE);
    RESC(alB); __syncthreads();
    SBAR(); qkt(pA0, pA1, K_lds, qr, r32, hi, cbase);
    if constexpr (MODE == 0) { apply_mask(pA0, pA1, mwa, hi); if (j + 3 < NT) mwa = MLOAD(j + 3); }
    finishSM(pB0, pB1, alB, l_reg, pa0, pa1, pa2, pa3); SBAR();
    if (j + 3 < NT) SLOAD(SE, (j + 3) * KVBLK); SBAR();
    pv_all<ND>(o, vb0 + SHM_T, pa0, pa1, pa2, pa3); partialSM(pA0, pA1, m_reg, mnA, alA);
    __syncthreads(); SWAIT(); SWRITE(1, SO);
    RESC(alA); __syncthreads();
  }
  SBAR(); qkt(pB0, pB1, K_lds + SHM_T, qr, r32, hi, cbase);
  if constexpr (MODE == 0) { apply_mask(pB0, pB1, mwb, hi); }
  if (lastdead) kill_tile(pB0, pB1);
  finishSM(pA0, pA1, alA, l_reg, pa0, pa1, pa2, pa3); SBAR();
  pv_all<ND>(o, vb0, pa0, pa1, pa2, pa3); partialSM(pB0, pB1, m_reg, mnB, alB);
  __syncthreads(); RESC(alB);
  finishSM(pB0, pB1, alB, l_reg, pa0, pa1, pa2, pa3); SBAR();
  pv_all<ND>(o, vb0 + SHM_T, pa0, pa1, pa2, pa3);
  if (hi == 0) li_l[r32] = l_reg; asm volatile("s_waitcnt lgkmcnt(0)" ::: "memory");
  float rli[16];
#pragma unroll
  for (int r = 0; r < 16; ++r) rli[r] = __builtin_amdgcn_rcpf(li_l[crow(r, hi)]);
  __syncthreads();
  float* X = (float*)lds;
  if constexpr (MODE == 0) {
#pragma unroll
    for (int r = 0; r < 16; ++r) { const int xr = qs * 32 + crow(r, hi);
#pragma unroll
      for (int d0 = 0; d0 < 2; ++d0) X[xr * 128 + c * 64 + d0 * 32 + r32] = o[d0][r] * rli[r]; }
  } else {
    if (c == 0) {
#pragma unroll
      for (int r = 0; r < 16; ++r) { const int xr = qs * 32 + crow(r, hi);
#pragma unroll
        for (int d0 = 0; d0 < 4; ++d0) X[xr * 128 + d0 * 32 + r32] = o[d0][r] * rli[r]; }
    }
    __syncthreads();
    if (c == 1) {
#pragma unroll
      for (int r = 0; r < 16; ++r) { const int xr = qs * 32 + crow(r, hi);
#pragma unroll
        for (int d0 = 0; d0 < 4; ++d0) X[xr * 128 + d0 * 32 + r32] -= lam * (o[d0][r] * rli[r]); }
    }
  }
  __syncthreads();
#pragma unroll 4
  for (int rr = 0; rr < 16; ++rr) { const int row = wid * 16 + rr; const f32x2 x = *reinterpret_cast<const f32x2*>(X + row * 128 + 2 * lane);
    const size_t grow = rowb + (size_t)qb * 128 + row;
    const unsigned gp = *reinterpret_cast<const unsigned*>(Z + grow * ZP + GC + hp * 128 + 2 * lane);
    float y0, y1;
    if constexpr (MODE == 0) { y0 = x.x * silu(bf_lo(gp)); y1 = x.y * silu(bf_hi(gp)); }
    else { const float ss = wave_sum(x.x * x.x + x.y * x.y); const float rn = __builtin_amdgcn_rsqf(ss * (1.0f / 128.0f) + EPS) * oml;
      const f32x2 sg = *reinterpret_cast<const f32x2*>(subg + 2 * lane);
      y0 = x.x * rn * sg.x * silu(bf_lo(gp)); y1 = x.y * rn * sg.y * silu(bf_hi(gp)); }
    *reinterpret_cast<unsigned*>(AO + grow * DM + (MODE ? 512 : 0) + hp * 128 + 2 * lane) = cvt_pk_bf16(y0, y1); }
  __syncthreads();
#undef SLOAD
#undef SWRITE
#undef SWAIT
#undef RESC
#undef MLOAD
}
#undef KSWZ
#undef SBAR
}

namespace sel {
using bf16x8 = __attribute__((ext_vector_type(8))) short;
typedef unsigned long long u64;
__device__ __forceinline__ void cnt4(int& cnt, float a, float b, float c, float d, float mid) {
  u64 m0, m1, m2, m3, dmp;
  asm volatile("v_cmp_ge_f32_e64 %1, %6, %10\n\tv_cmp_ge_f32_e64 %2, %7, %10\n\tv_cmp_ge_f32_e64 %3, %8, %10\n\tv_cmp_ge_f32_e64 %4, %9, %10\n\t"
               "v_addc_co_u32_e64 %0, %5, %0, 0, %1\n\tv_addc_co_u32_e64 %0, %5, %0, 0, %2\n\tv_addc_co_u32_e64 %0, %5, %0, 0, %3\n\tv_addc_co_u32_e64 %0, %5, %0, 0, %4"
               : "+v"(cnt), "=&s"(m0), "=&s"(m1), "=&s"(m2), "=&s"(m3), "=&s"(dmp) : "v"(a), "v"(b), "v"(c), "v"(d), "v"(mid));
}
__device__ __forceinline__ void bits4_ge(unsigned& w, float a, float b, float c, float d, float t) {
  u64 m0, m1, m2, m3, dmp;
  asm volatile("v_cmp_ge_f32_e64 %1, %6, %10\n\tv_cmp_ge_f32_e64 %2, %7, %10\n\tv_cmp_ge_f32_e64 %3, %8, %10\n\tv_cmp_ge_f32_e64 %4, %9, %10\n\t"
               "v_addc_co_u32_e64 %0, %5, %0, %0, %1\n\tv_addc_co_u32_e64 %0, %5, %0, %0, %2\n\tv_addc_co_u32_e64 %0, %5, %0, %0, %3\n\tv_addc_co_u32_e64 %0, %5, %0, %0, %4"
               : "+v"(w), "=&s"(m0), "=&s"(m1), "=&s"(m2), "=&s"(m3), "=&s"(dmp) : "v"(a), "v"(b), "v"(c), "v"(d), "v"(t));
}
__device__ __forceinline__ void bits4_eq(unsigned& w, float a, float b, float c, float d, float t) {
  u64 m0, m1, m2, m3, dmp;
  asm volatile("v_cmp_eq_f32_e64 %1, %6, %10\n\tv_cmp_eq_f32_e64 %2, %7, %10\n\tv_cmp_eq_f32_e64 %3, %8, %10\n\tv_cmp_eq_f32_e64 %4, %9, %10\n\t"
               "v_addc_co_u32_e64 %0, %5, %0, %0, %1\n\tv_addc_co_u32_e64 %0, %5, %0, %0, %2\n\tv_addc_co_u32_e64 %0, %5, %0, %0, %3\n\tv_addc_co_u32_e64 %0, %5, %0, %0, %4"
               : "+v"(w), "=&s"(m0), "=&s"(m1), "=&s"(m2), "=&s"(m3), "=&s"(dmp) : "v"(a), "v"(b), "v"(c), "v"(d), "v"(t));
}
__device__ __forceinline__ unsigned lowbits(int n) { return n >= 32 ? 0xffffffffu : ((1u << n) - 1u); }
__device__ __forceinline__ int clampi(int v, int lo, int hi) { return v < lo ? lo : (v > hi ? hi : v); }
__device__ __forceinline__ unsigned idx_mask_word(int w, int mrel) {
  if (mrel <= 0) return 0u;
  const int gq = mrel >> 8, rem = mrel & 255;
  unsigned m = lowbits(clampi(8 * gq - 32 * w, 0, 32));
  if ((gq >> 2) == w) { const unsigned pb = lowbits(clampi(rem, 0, 4)) | (lowbits(clampi(rem - 16, 0, 4)) << 4); m |= pb << (8 * (gq & 3)); }
  return m;
}
__device__ __forceinline__ void sel_unit(const bf16_t* __restrict__ Z, unsigned* __restrict__ mask, int b, int qt, LAS int* red) {
  const int tid = ltid(), wid = __builtin_amdgcn_readfirstlane(tid >> 6), lane = tid & 63, q = lane & 15, kg = lane >> 4;
  const int t0 = qt * 16, L = ((qt >> 2) + 1) * 64, nG = L >> 5;
  const int ngw = (nG > wid) ? ((nG - wid + 7) >> 3) : 0;
  const size_t rowb = (size_t)b * S;
  const bf16_t* qrow = Z + (rowb + t0 + q) * ZP;
  bf16x8 bq[4][2];
#pragma unroll
  for (int h = 0; h < 4; ++h)
#pragma unroll
    for (int kk = 0; kk < 2; ++kk) bq[h][kk] = *reinterpret_cast<const bf16x8*>(qrow + C_QI + 64 * h + 32 * kk + 8 * kg);
  float wq[4];
  { const v2u ww = *reinterpret_cast<const v2u*>(qrow + C_WI); wq[0] = bf_lo(ww.x) * 0.0625f; wq[1] = bf_hi(ww.x) * 0.0625f; wq[2] = bf_lo(ww.y) * 0.0625f; wq[3] = bf_hi(ww.y) * 0.0625f; }
  float sc[16][2][4];
  const float NINF = -INFINITY;
#pragma unroll
  for (int g = 0; g < 16; ++g) {
    if (g < ngw) {
      const int G = wid + 8 * g;
#pragma unroll
      for (int hf = 0; hf < 2; ++hf) {
        const bf16_t* kp = Z + (rowb + 32 * G + 16 * hf + q) * ZP + C_KI + 8 * kg;
        const bf16x8 a0 = *reinterpret_cast<const bf16x8*>(kp), a1 = *reinterpret_cast<const bf16x8*>(kp + 32);
        f32x4 s4 = {0.f, 0.f, 0.f, 0.f};
#pragma unroll
        for (int h = 0; h < 4; ++h) { f32x4 a = {0.f, 0.f, 0.f, 0.f};
          a = __builtin_amdgcn_mfma_f32_16x16x32_bf16(a0, bq[h][0], a, 0, 0, 0);
          a = __builtin_amdgcn_mfma_f32_16x16x32_bf16(a1, bq[h][1], a, 0, 0, 0);
#pragma unroll
          for (int i = 0; i < 4; ++i) s4[i] += wq[h] * fmaxf(a[i], 0.f); }
#pragma unroll
        for (int i = 0; i < 4; ++i) sc[g][hf][i] = s4[i];
      }
    } else {
#pragma unroll
      for (int hf = 0; hf < 2; ++hf)
#pragma unroll
        for (int i = 0; i < 4; ++i) sc[g][hf][i] = NINF;
    }
  }
  int par = 0;
#define RED_BEGIN() do { par ^= 1; } while (0)
#define RED_PUT(slot, ival) do { int v_ = (ival); v_ += __shfl_xor(v_, 16); v_ += __shfl_xor(v_, 32); if (lane < 16) red[((par * 8 + wid) * 16 + q) * 4 + (slot)] = v_; } while (0)
#define RED_PUTF(slot, fval, OP) do { float v_ = (fval); v_ = OP(v_, __shfl_xor(v_, 16)); v_ = OP(v_, __shfl_xor(v_, 32)); if (lane < 16) red[((par * 8 + wid) * 16 + q) * 4 + (slot)] = __float_as_int(v_); } while (0)
#define RED_SYNC() __syncthreads()
#define RED_GET(slot, w) (red[((par * 8 + (w)) * 16 + q) * 4 + (slot)])
  float thr = NINF; bool tie = false; int need = 0;
  if (L > 256) {
    float mx = NINF, mn = INFINITY; int cpos = 0, cnn = 0;
#pragma unroll
    for (int g = 0; g < 16; ++g) if (g < ngw) {
#pragma unroll
      for (int hf = 0; hf < 2; ++hf)
#pragma unroll
        for (int i = 0; i < 4; ++i) { const float v = sc[g][hf][i]; mx = fmaxf(mx, v); mn = fminf(mn, v); cpos += (v > 0.f) ? 1 : 0; cnn += (v >= 0.f) ? 1 : 0; }
    }
    RED_BEGIN(); RED_PUTF(0, mx, fmaxf); RED_PUTF(1, mn, fminf); RED_PUT(2, cpos); RED_PUT(3, cnn); RED_SYNC();
    mx = NINF; mn = INFINITY; cpos = 0; cnn = 0;
#pragma unroll
    for (int w = 0; w < 8; ++w) { mx = fmaxf(mx, __int_as_float(RED_GET(0, w))); mn = fminf(mn, __int_as_float(RED_GET(1, w))); cpos += RED_GET(2, w); cnn += RED_GET(3, w); }
    float lo, hi; int chi; bool done = false;
    if (cpos >= 256) { lo = 0.f; hi = __uint_as_float(__float_as_uint(mx) + 1u); chi = 0; }
    else if (cnn >= 256) { lo = 0.f; hi = 0.f; chi = cpos; thr = 0.f; tie = true; need = 256 - cpos; done = true; }
    else { lo = mn; hi = 0.f; chi = cnn; }
    for (int it = 0; it < 80; ++it) {
      if (__all(done)) break;
      const float mid = 0.5f * (lo + hi);
      if (!done && (mid <= lo || mid >= hi)) { thr = lo; tie = true; need = 256 - chi; done = true; }
      int cnt = 0; int ngl = ngw; asm volatile("" : "+s"(ngl));
#pragma unroll
      for (int g = 0; g < 16; ++g) if (g < ngl) {
        cnt4(cnt, sc[g][0][0], sc[g][0][1], sc[g][0][2], sc[g][0][3], mid);
        cnt4(cnt, sc[g][1][0], sc[g][1][1], sc[g][1][2], sc[g][1][3], mid);
      }
      RED_BEGIN(); RED_PUT(0, cnt); RED_SYNC();
      cnt = 0;
#pragma unroll
      for (int w = 0; w < 8; ++w) cnt += RED_GET(0, w);
      if (!done) { if (cnt == 256) { thr = mid; done = true; } else if (cnt > 256) { lo = mid; } else { hi = mid; chi = cnt; } }
    }
    if (!done) { thr = lo; tie = true; need = 256 - chi; if (need < 1) need = 1; }
  }
  unsigned SB[4];
#pragma unroll
  for (int w = 0; w < 4; ++w) { unsigned acc = 0u;
#pragma unroll
    for (int k = 3; k >= 0; --k) { const int g = 4 * w + k;
      bits4_ge(acc, sc[g][1][3], sc[g][1][2], sc[g][1][1], sc[g][1][0], thr);
      bits4_ge(acc, sc[g][0][3], sc[g][0][2], sc[g][0][1], sc[g][0][0], thr); }
    SB[w] = acc; }
  if (__any(tie)) {
    unsigned EQ[4];
#pragma unroll
    for (int w = 0; w < 4; ++w) { unsigned acc = 0u;
#pragma unroll
      for (int k = 3; k >= 0; --k) { const int g = 4 * w + k;
        bits4_eq(acc, sc[g][1][3], sc[g][1][2], sc[g][1][1], sc[g][1][0], thr);
        bits4_eq(acc, sc[g][0][3], sc[g][0][2], sc[g][0][1], sc[g][0][0], thr); }
      EQ[w] = acc; }
    const int lbase = 32 * wid + 4 * kg;
    int mlo = tie ? 0 : L - 1, mhi = L;
    for (int it = 0; it < 13; ++it) {
      if (__all(mhi - mlo <= 1)) break;
      const int mm = (mlo + mhi) >> 1; int cnt = 0;
#pragma unroll
      for (int w = 0; w < 4; ++w) cnt += __popc(EQ[w] & idx_mask_word(w, mm - lbase));
      RED_BEGIN(); RED_PUT(0, cnt); RED_SYNC();
      cnt = 0;
#pragma unroll
      for (int w = 0; w < 8; ++w) cnt += RED_GET(0, w);
      if (mhi - mlo > 1) { if (cnt >= need) mhi = mm; else mlo = mm; }
    }
    if (tie) {
#pragma unroll
      for (int w = 0; w < 4; ++w) SB[w] &= ~(EQ[w] & ~idx_mask_word(w, mhi - lbase));
    }
  }
  {
    unsigned* mq = mask + (rowb + t0 + q) * 128;
#pragma unroll
    for (int g = 0; g < 16; ++g) if (g < ngw) {
      const unsigned by = (SB[g >> 2] >> (8 * (g & 3))) & 0xffu;
      unsigned wbits = ((by & 0xfu) << (4 * kg)) | ((by >> 4) << (16 + 4 * kg));
      wbits |= __shfl_xor(wbits, 16); wbits |= __shfl_xor(wbits, 32);
      if (lane < 16) mq[wid + 8 * g] = wbits;
    }
  }
  __syncthreads();
#undef RED_BEGIN
#undef RED_PUT
#undef RED_PUTF
#undef RED_SYNC
#undef RED_GET
}
}

constexpr size_t MiB = 1u << 20;
constexpr size_t WS_CTL = 0, CTL_ZERO_BYTES = 1 * MiB;
constexpr size_t WS_SMALL = 1 * MiB;
constexpr size_t SM_LAM = 0, SM_CS = 4096, SM_RSTD = SM_CS + (size_t)S * 16 * 4;
constexpr size_t WS_W = 2 * MiB;
constexpr size_t W_IN = 0, W_O = (size_t)ZP * DM * 2, W_G = W_O + (size_t)DM * DM * 2, W_P = W_G + (size_t)DM * DM * 2, W_LAYER = W_P + (size_t)DM * DPLE * 2;
constexpr size_t WS_MASK = WS_W + 54 * MiB;
constexpr size_t WS_XB = WS_MASK + 16 * MiB;
constexpr size_t WS_PB = WS_XB + 64 * MiB;
constexpr size_t WS_Z = WS_PB + 64 * MiB;
constexpr size_t WS_Y = WS_Z, WS_PE = WS_Z + 64 * MiB, WS_E = WS_Z + 128 * MiB;
constexpr size_t WS_END = WS_Z + (size_t)M * ZP * 2;
static_assert(W_LAYER * DEPTH <= 54 * MiB && SM_RSTD + (size_t)M * 4 <= 1 * MiB && WS_END <= 512 * MiB, "d_ws map");
constexpr int CW_BAR = 4096;

constexpr int LDS_BYTES = 147456, MISC_OFF = 131072 + 320;

#define XB_TMO      128
#define XB_XCNT(j)  (256  + 64 * (j))
#define XB_XSUB(j)  (1280 + 64 * (j))
#define XB_XGEN(j)  (2304 + 64 * (j))
#define XB_TOP      3328
#define XB_TOPGEN   3392
#define XCD_BAR_WORDS 3456
#define XB_SPIN_CAP (1u << 18)
__device__ __forceinline__ unsigned xb_ld(unsigned* p)              { return __hip_atomic_load(p, __ATOMIC_RELAXED, __HIP_MEMORY_SCOPE_AGENT); }
__device__ __forceinline__ unsigned xb_add(unsigned* p, unsigned v) { return __hip_atomic_fetch_add(p, v, __ATOMIC_RELAXED, __HIP_MEMORY_SCOPE_AGENT); }
__device__ __forceinline__ unsigned xb_xcc_id() { return (unsigned)__builtin_amdgcn_s_getreg((3 << 11) | 20) & 0xFu; }
#define XB_SPIN(cond, bar) do { unsigned _sp = 0; while (cond) { __builtin_amdgcn_s_sleep(1); \
    if ((++_sp & 255u) == 0u) { if (xb_ld(&(bar)[XB_TMO])) break; if (_sp > XB_SPIN_CAP) { atomicAdd(&(bar)[XB_TMO], 1u); break; } } } } while (0)
struct XcdBarrier { unsigned* bar; unsigned x; volatile LAS unsigned* st; };
__device__ __forceinline__ XcdBarrier xcd_barrier_post(unsigned* bar, volatile LAS unsigned* st) {
    XcdBarrier b; b.bar = bar; b.x = xb_xcc_id(); b.st = st;
    if (threadIdx.x == 0) (void)xb_add(&bar[XB_XCNT(b.x)], 1u);
    return b;
}
__device__ __forceinline__ void xcd_barrier_complete(unsigned* bar, unsigned x, unsigned& nloc, unsigned& nx) {
    const unsigned G = gridDim.x * gridDim.y * gridDim.z;
    unsigned sum, cnt, mine, sp = 0u;
    for (;;) {
        sum = 0u; cnt = 0u; mine = 0u;
#pragma unroll
        for (unsigned j = 0; j < 16; ++j) { const unsigned c = xb_ld(&bar[XB_XCNT(j)]); sum += c; cnt += (c > 0u) ? 1u : 0u; mine = (j == x) ? c : mine; }
        if (sum == G) break;
        __builtin_amdgcn_s_sleep(1);
        if ((++sp & 255u) == 0u) { if (xb_ld(&bar[XB_TMO])) break; if (sp > XB_SPIN_CAP) { atomicAdd(&bar[XB_TMO], 1u); break; } }
    }
    nloc = mine > 0u ? mine : 1u; nx = cnt > 0u ? cnt : 1u;
}
__device__ __forceinline__ void xcd_barrier(const XcdBarrier& b) {
    asm volatile("s_waitcnt vmcnt(0)" ::: "memory");
    __syncthreads();
    if (threadIdx.x == 0) {
        unsigned* bar = b.bar;
        __builtin_amdgcn_s_waitcnt(0);
        unsigned nloc = b.st[0], nx = b.st[1];
        if (nloc == 0u) { xcd_barrier_complete(bar, b.x, nloc, nx); b.st[0] = nloc; b.st[1] = nx; }
        const unsigned old = xb_add(&bar[XB_XSUB(b.x)], 1u);
        const unsigned gen = old / nloc;
        if (old + 1u == (gen + 1u) * nloc) {
            __builtin_amdgcn_fence(__ATOMIC_RELEASE, "agent");
            asm volatile("s_waitcnt vmcnt(0)" ::: "memory");
            const unsigned og = xb_add(&bar[XB_TOP], 1u);
            const unsigned tg = og / nx;
            if (og + 1u == (tg + 1u) * nx) xb_add(&bar[XB_TOPGEN], 1u);
            else XB_SPIN(xb_ld(&bar[XB_TOPGEN]) == tg, bar);
            __builtin_amdgcn_fence(__ATOMIC_ACQUIRE, "agent");
            xb_add(&bar[XB_XGEN(b.x)], 1u);
            asm volatile("s_waitcnt vmcnt(0)" ::: "memory");
        } else {
            XB_SPIN(xb_ld(&bar[XB_XGEN(b.x)]) == gen, bar);
            __builtin_amdgcn_fence(__ATOMIC_ACQUIRE, "agent");
            asm volatile("s_waitcnt vmcnt(0)" ::: "memory");
        }
    }
    __syncthreads();
}

__device__ __forceinline__ float wave_sum(float v) {
#pragma unroll
    for (int o = 1; o < 64; o <<= 1) v += __shfl_xor(v, o);
    return v;
}
__device__ __forceinline__ void transpose_item(const float* __restrict__ W, int ldw, int srccol0, int nvalid, const float* __restrict__ gk, bf16_t* __restrict__ WT, int K, int dstrow0, LAS float* scr, int k0, int lane) {
#pragma unroll 8
    for (int i = 0; i < 32; ++i) { const int kk = 2 * i + (lane >> 5), c = lane & 31; float v = (c < nvalid) ? W[(size_t)(k0 + kk) * ldw + srccol0 + c] : 0.f; if (gk) v *= gk[k0 + kk]; scr[kk * 33 + c] = v; }
    asm volatile("s_waitcnt lgkmcnt(0)" ::: "memory");
    const int c8 = lane & 7;
#pragma unroll
    for (int j = 0; j < 4; ++j) { const int n = (lane >> 3) + 8 * j; const LAS float* s = scr + (8 * c8) * 33 + n;
        v4u o; o.x = cvt_pk_bf16(s[0 * 33], s[1 * 33]); o.y = cvt_pk_bf16(s[2 * 33], s[3 * 33]); o.z = cvt_pk_bf16(s[4 * 33], s[5 * 33]); o.w = cvt_pk_bf16(s[6 * 33], s[7 * 33]);
        *(v4u*)(WT + (size_t)(dstrow0 + n) * K + k0 + 8 * c8) = o; }
    asm volatile("s_waitcnt lgkmcnt(0)" ::: "memory");
}
__device__ __forceinline__ void zcol_map(int n0, int& src, int& nvalid) {
    nvalid = 32;
    if (n0 < 1536) src = n0;
    else if (n0 < 3072) src = 2372 + (n0 - 1536);
    else if (n0 < 3584) src = 1860 + (n0 - 3072);
    else if (n0 < 4096) src = 3908 + (n0 - 3584);
    else if (n0 < 4352) src = 1536 + (n0 - 4096);
    else if (n0 < 4416) src = 1792 + (n0 - 4352);
    else if (n0 == 4416) { src = 1856; nvalid = 4; }
    else { src = 0; nvalid = 0; }
}

struct Args { const float* in[14]; float* out; unsigned char* ws; int ph_lo, ph_hi; };
constexpr int NPHASE = 1 + 7 * DEPTH;
struct LamInit { float v[4]; };

__global__ void __launch_bounds__(512, 2) fwd(Args args) {
    extern __shared__ __attribute__((aligned(16))) unsigned char lds[];
    LAS unsigned char* ldsl = (LAS unsigned char*)lds;
    volatile LAS unsigned* MISC = (volatile LAS unsigned*)(ldsl + MISC_OFF);
    const int tid = threadIdx.x, lane = tid & 63, wave = __builtin_amdgcn_readfirstlane(tid >> 6);
    const int G = gridDim.x; const int bx = blockIdx.x; const int vcu = (G % 8 == 0) ? (bx % 8) * (G / 8) + bx / 8 : bx;
    for (int u = tid; u < (LDS_BYTES - 131072) / 4; u += 512) ((LAS unsigned*)(ldsl + 131072))[u] = 0u;
    __syncthreads();
    XcdBarrier bar; { unsigned* ctl0 = (unsigned*)(args.ws + WS_CTL); bar.bar = ctl0 + CW_BAR; bar.x = 0; bar.st = nullptr;
      if (!MK_PER_PHASE) bar = xcd_barrier_post(ctl0 + CW_BAR, MISC + 8); }
    const int lo = args.ph_lo, hi = args.ph_hi;
#define KA() ({ unsigned long long a_ = (unsigned long long)__builtin_amdgcn_kernarg_segment_ptr(); asm volatile("" : "+s"(a_)); (const __attribute__((address_space(4))) Args*)a_; })
#define IN(k) (lo <= (k) && (k) < hi)
#define SEAM(k) do { if (!MK_PER_PHASE && IN((k) + 1)) xcd_barrier(bar); } while (0)
    const int gw = vcu * 8 + wave, NGW = G * 8;

    if (IN(0)) {
        const auto A = KA(); unsigned char* ws = A->ws;
        const float* x_in = A->in[0]; const float* p_in = A->in[1]; const float* pre_g = A->in[2]; const float* w_in = A->in[3]; const float* w_out = A->in[4];
        const float* w_gate = A->in[11]; const float* w_proj = A->in[12];
        float* LAM = (float*)(ws + WS_SMALL + SM_LAM); float* CS = (float*)(ws + WS_SMALL + SM_CS); float* RSTD = (float*)(ws + WS_SMALL + SM_RSTD);
        bf16_t* XB = (bf16_t*)(ws + WS_XB); bf16_t* PB = (bf16_t*)(ws + WS_PB);
        LAS float* scr = (LAS float*)(ldsl + wave * 16384);
        constexpr int I_IN = (DM / 64) * (ZP / 32), I_O = (DM / 64) * (DM / 32), I_G = I_O, I_P = (DPLE / 64) * (DM / 32), I_L = I_IN + I_O + I_G + I_P;
        for (int it = gw; it < I_L * DEPTH; it += NGW) {
            const int l = it / I_L; int r = it % I_L; bf16_t* wl = (bf16_t*)(ws + WS_W + (size_t)l * W_LAYER);
            if (r < I_IN) { const int nblk = ZP / 32, kb = r / nblk, nb = r % nblk; int src, nv; zcol_map(32 * nb, src, nv);
                transpose_item(w_in + (size_t)l * DM * DIN, DIN, src, nv, pre_g + l * DM, (bf16_t*)((char*)wl + W_IN), DM, 32 * nb, scr, 64 * kb, lane); continue; }
            r -= I_IN;
            if (r < I_O) { const int nblk = DM / 32, kb = r / nblk, nb = r % nblk;
                transpose_item(w_out + (size_t)l * DM * DM, DM, 32 * nb, 32, nullptr, (bf16_t*)((char*)wl + W_O), DM, 32 * nb, scr, 64 * kb, lane); continue; }
            r -= I_O;
            if (r < I_G) { const int nblk = DM / 32, kb = r / nblk, nb = r % nblk;
                transpose_item(w_gate + (size_t)l * DM * DM, DM, 32 * nb, 32, nullptr, (bf16_t*)((char*)wl + W_G), DM, 32 * nb, scr, 64 * kb, lane); continue; }
            r -= I_G;
            { const int nblk = DM / 32, kb = r / nblk, nb = r % nblk;
                transpose_item(w_proj + (size_t)l * DPLE * DM, DM, 32 * nb, 32, nullptr, (bf16_t*)((char*)wl + W_P), DPLE, 32 * nb, scr, 64 * kb, lane); }
        }
        for (int m = gw; m < M; m += NGW) {
            const f32x4* xr = (const f32x4*)(x_in + (size_t)m * DM) + lane; f32x4 v[4]; float s = 0.f;
#pragma unroll
            for (int j = 0; j < 4; ++j) { v[j] = xr[64 * j]; s += (v[j].x * v[j].x + v[j].y * v[j].y) + (v[j].z * v[j].z + v[j].w * v[j].w); }
            s = wave_sum(s);
            v2u* o8 = (v2u*)(XB + (size_t)m * DM) + lane;
#pragma unroll
            for (int j = 0; j < 4; ++j) { v2u w; w.x = cvt_pk_bf16(v[j].x, v[j].y); w.y = cvt_pk_bf16(v[j].z, v[j].w); o8[64 * j] = w; }
            if (lane == 0) RSTD[m] = __builtin_amdgcn_rsqf(s * (1.0f / DM) + EPS);
        }
        { const size_t n8 = (size_t)DEPTH * M * DPLE / 8;
          for (size_t i = (size_t)gw * 64 + lane; i < n8; i += (size_t)NGW * 64) { const f32x4 a = *((const f32x4*)p_in + 2 * i), c = *((const f32x4*)p_in + 2 * i + 1);
              v4u w; w.x = cvt_pk_bf16(a.x, a.y); w.y = cvt_pk_bf16(a.z, a.w); w.z = cvt_pk_bf16(c.x, c.y); w.w = cvt_pk_bf16(c.z, c.w); *((v4u*)PB + i) = w; } }
        for (int i = gw * 64 + lane; i < S * 8; i += NGW * 64) { const int pos = i >> 3, j = i & 7;
            const float inv = __builtin_powf(500000.0f, -(float)j * 0.125f); const float ang = (float)pos * inv;
            const double rev = (double)ang * 0.15915494309189535; const float fr = (float)(rev - __builtin_rint(rev));
            CS[pos * 16 + j] = __builtin_amdgcn_cosf(fr); CS[pos * 16 + 8 + j] = __builtin_amdgcn_sinf(fr); }
        if (gw < DEPTH) { const float* lq1 = A->in[6]; const float* lk1 = A->in[7]; const float* lq2 = A->in[8]; const float* lk2 = A->in[9];
            const int l = gw; const float a = wave_sum(lq1[l * 64 + lane] * lk1[l * 64 + lane]), c = wave_sum(lq2[l * 64 + lane] * lk2[l * 64 + lane]);
            const float li = 0.8f - 0.6f * __expf(-0.3f * (float)l);
            if (lane == 0) LAM[l] = __expf(a) - __expf(c) + li; }
        SEAM(0);
    }

    for (int l = 0; l < DEPTH; ++l) {
        const int pb = 1 + 7 * l;
#ifndef NO_G1
        if (IN(pb + 0)) {
            const auto A = KA(); unsigned char* ws = A->ws;
            pg8::Gemm g{(const bf16_t*)(ws + WS_XB), (const bf16_t*)(ws + WS_W + (size_t)l * W_LAYER + W_IN), M, ZP, DM}; pg8::StaticOrder So; So.init(M, ZP, G, bx);
            pg8::EpiZ Ep{(bf16_t*)(ws + WS_Z), (const float*)(ws + WS_SMALL + SM_RSTD), (const float*)(ws + WS_SMALL + SM_CS)};
            pg8::gemm_phase<pg8::EpiZ, pg8::StaticOrder, true, true>(ldsl, g, So, Ep);
            SEAM(pb + 0);
        }
#endif
#ifndef NO_SEL
        if (IN(pb + 1)) {
            const auto A = KA(); unsigned char* ws = A->ws;
            const int b = vcu >> 5, s = vcu & 31;
            for (int i = 0; i < 8; ++i) { const int qt = (i & 1) ? (255 - 32 * (i >> 1) - s) : (32 * (i >> 1) + s);
                sel::sel_unit((const bf16_t*)(ws + WS_Z), (unsigned*)(ws + WS_MASK), b, qt, (LAS int*)ldsl); }
            SEAM(pb + 1);
        }
#endif
#ifndef NO_ATT
        if (IN(pb + 2)) {
            const auto A = KA(); unsigned char* ws = A->ws;
            const bf16_t* Z = (const bf16_t*)(ws + WS_Z); const unsigned* MASK = (const unsigned*)(ws + WS_MASK); bf16_t* AO = (bf16_t*)A->out;
            const float* subg = A->in[10] + l * 128;
            const int b = vcu >> 5, hp = (vcu >> 3) & 3, s = vcu & 7;
            const float lam = ((const float*)(ws + WS_SMALL + SM_LAM))[l]; const float oml = 1.0f - (0.8f - 0.6f * __expf(-0.3f * (float)l));
            for (int i = 0; i < 4; ++i) { const int qb = (i == 0) ? s : (i == 1) ? 15 - s : (i == 2) ? 16 + s : 31 - s;
                att::attn_unit<1>(Z, MASK, AO, b, hp, qb, (char*)lds, lam, subg, oml); }
            for (int i = 0; i < 4; ++i) { const int qb = (i == 0) ? s : (i == 1) ? 15 - s : (i == 2) ? 16 + s : 31 - s;
                att::attn_unit<0>(Z, MASK, AO, b, hp, qb, (char*)lds, lam, subg, oml); }
            SEAM(pb + 2);
        }
#endif
#ifndef NO_G2
        if (IN(pb + 3)) {
            { const auto A = KA(); unsigned char* ws = A->ws;
              pg8::Gemm g{(const bf16_t*)A->out, (const bf16_t*)(ws + WS_W + (size_t)l * W_LAYER + W_O), M, DM, DM}; pg8::StaticOrder So; So.init(M, DM, G, bx); pg8::EpiStore Ep{(bf16_t*)(ws + WS_Y), DM};
              pg8::gemm_phase<pg8::EpiStore, pg8::StaticOrder, true, true>(ldsl, g, So, Ep); }
            { const auto A = KA(); unsigned char* ws = A->ws;
              pg8::Gemm g{(const bf16_t*)(ws + WS_PB) + (size_t)l * M * DPLE, (const bf16_t*)(ws + WS_W + (size_t)l * W_LAYER + W_P), M, DM, DPLE}; pg8::StaticOrder So; So.init(M, DM, G, bx); pg8::EpiStore Ep{(bf16_t*)(ws + WS_PE), DM};
              pg8::gemm_phase<pg8::EpiStore, pg8::StaticOrder, true, true>(ldsl, g, So, Ep); }
            SEAM(pb + 3);
        }
#endif
        if (IN(pb + 4)) {
            const auto A = KA(); unsigned char* ws = A->ws; const int tid = ltid(), lane = tid & 63, wave = __builtin_amdgcn_readfirstlane(tid >> 6), gw = vcu * 8 + wave;
            const float* gp = A->in[5] + l * DM; const bf16_t* Y = (const bf16_t*)(ws + WS_Y); bf16_t* XB = (bf16_t*)(ws + WS_XB);
            for (int m = gw; m < M; m += NGW) {
                const v2u* yr = (const v2u*)(Y + (size_t)m * DM) + lane; v2u* xr = (v2u*)(XB + (size_t)m * DM) + lane; const f32x4* gr = (const f32x4*)gp + lane;
                v2u yv[4], xv[4]; float s = 0.f;
#pragma unroll
                for (int j = 0; j < 4; ++j) { yv[j] = yr[64 * j]; xv[j] = xr[64 * j]; }
#pragma unroll
                for (int j = 0; j < 4; ++j) { const float a = bf_lo(yv[j].x), b2 = bf_hi(yv[j].x), c = bf_lo(yv[j].y), d = bf_hi(yv[j].y); s += (a * a + b2 * b2) + (c * c + d * d); }
                s = wave_sum(s); const float rn = __builtin_amdgcn_rsqf(s * (1.0f / DM) + EPS);
#pragma unroll
                for (int j = 0; j < 4; ++j) { const f32x4 gv = gr[64 * j];
                    const float a = bf_lo(xv[j].x) + bf_lo(yv[j].x) * rn * gv.x, b2 = bf_hi(xv[j].x) + bf_hi(yv[j].x) * rn * gv.y;
                    const float c = bf_lo(xv[j].y) + bf_lo(yv[j].y) * rn * gv.z, d = bf_hi(xv[j].y) + bf_hi(yv[j].y) * rn * gv.w;
                    v2u w; w.x = cvt_pk_bf16(a, b2); w.y = cvt_pk_bf16(c, d); xr[64 * j] = w; }
            }
            SEAM(pb + 4);
        }
#ifndef NO_G3
        if (IN(pb + 5)) {
            const auto A = KA(); unsigned char* ws = A->ws;
            pg8::Gemm g{(const bf16_t*)(ws + WS_XB), (const bf16_t*)(ws + WS_W + (size_t)l * W_LAYER + W_G), M, DM, DM}; pg8::StaticOrder So; So.init(M, DM, G, bx); pg8::EpiGate Ep{(bf16_t*)(ws + WS_E), (const bf16_t*)(ws + WS_PE), DM};
            pg8::gemm_phase<pg8::EpiGate, pg8::StaticOrder, true, true>(ldsl, g, So, Ep);
            SEAM(pb + 5);
        }
#endif
        if (IN(pb + 6)) {
            const auto A = KA(); unsigned char* ws = A->ws; const int tid = ltid(), lane = tid & 63, wave = __builtin_amdgcn_readfirstlane(tid >> 6), gw = vcu * 8 + wave;
            const float* gp = A->in[13] + l * DM; const bool lastl = (l == DEPTH - 1); const bf16_t* E = (const bf16_t*)(ws + WS_E); bf16_t* XB = (bf16_t*)(ws + WS_XB);
            float* RSTD = (float*)(ws + WS_SMALL + SM_RSTD); float* outp = A->out;
            for (int m = gw; m < M; m += NGW) {
                const v2u* er = (const v2u*)(E + (size_t)m * DM) + lane; v2u* xr = (v2u*)(XB + (size_t)m * DM) + lane; const f32x4* gr = (const f32x4*)gp + lane;
                v2u ev[4], xv[4]; float s = 0.f;
#pragma unroll
                for (int j = 0; j < 4; ++j) { ev[j] = er[64 * j]; xv[j] = xr[64 * j]; }
#pragma unroll
                for (int j = 0; j < 4; ++j) { const float a = bf_lo(ev[j].x), b2 = bf_hi(ev[j].x), c = bf_lo(ev[j].y), d = bf_hi(ev[j].y); s += (a * a + b2 * b2) + (c * c + d * d); }
                s = wave_sum(s); const float rn = __builtin_amdgcn_rsqf(s * (1.0f / DM) + EPS);
                float s2 = 0.f; f32x4* orow = (f32x4*)(outp + (size_t)m * DM) + lane;
#pragma unroll
                for (int j = 0; j < 4; ++j) { const f32x4 gv = gr[64 * j];
                    const float a = bf_lo(xv[j].x) + bf_lo(ev[j].x) * rn * gv.x, b2 = bf_hi(xv[j].x) + bf_hi(ev[j].x) * rn * gv.y;
                    const float c = bf_lo(xv[j].y) + bf_lo(ev[j].y) * rn * gv.z, d = bf_hi(xv[j].y) + bf_hi(ev[j].y) * rn * gv.w;
                    s2 += (a * a + b2 * b2) + (c * c + d * d);
                    if (lastl) { orow[64 * j] = (f32x4){a, b2, c, d}; }
                    else { v2u w; w.x = cvt_pk_bf16(a, b2); w.y = cvt_pk_bf16(c, d); xr[64 * j] = w; } }
                s2 = wave_sum(s2);
                if (!lastl && lane == 0) RSTD[m] = __builtin_amdgcn_rsqf(s2 * (1.0f / DM) + EPS);
            }
            if (!lastl) SEAM(pb + 6);
        }
    }
#undef IN
#undef SEAM
}

extern "C" void kernel_launch(void* const* d_in, const int* in_sizes, int n_in, void* d_out, int out_size, void* d_ws, size_t ws_size, hipStream_t stream) {
    static int grid = 0;
    if (grid == 0) {
        if (n_in != 14 || out_size != M * DM || ws_size < WS_END) { fprintf(stderr, "kernel_launch: unexpected shapes: n_in %d out %d ws %zu (need %zu)\n", n_in, out_size, ws_size, (size_t)WS_END); grid = -1; return; }
        int dev = 0, cus = 0, per_cu = 0;
        if (hipGetDevice(&dev) != hipSuccess || hipDeviceGetAttribute(&cus, hipDeviceAttributeMultiprocessorCount, dev) != hipSuccess) { grid = -1; return; }
        if (hipFuncSetAttribute((const void*)fwd, hipFuncAttributeMaxDynamicSharedMemorySize, LDS_BYTES) != hipSuccess) { fprintf(stderr, "kernel_launch: hipFuncSetAttribute failed\n"); grid = -1; return; }
        if (hipOccupancyMaxActiveBlocksPerMultiprocessor(&per_cu, (const void*)fwd, 512, LDS_BYTES) != hipSuccess || per_cu < 1) fprintf(stderr, "kernel_launch: occupancy query says %d\n", per_cu);
        (void)hipGetLastError();
        grid = cus;
        if (grid != 256) fprintf(stderr, "kernel_launch: %d CUs (the work deal assumes 256)\n", grid);
    }
    if (grid < 0) return;
    if (hipMemsetAsync((char*)d_ws + WS_CTL, 0, CTL_ZERO_BYTES, stream) != hipSuccess) return;
    Args a{};
    for (int i = 0; i < 14; ++i) a.in[i] = (const float*)d_in[i];
    a.out = (float*)d_out; a.ws = (unsigned char*)d_ws;
#if MK_PER_PHASE
    for (int ph = 0; ph < NPHASE; ++ph) { a.ph_lo = ph; a.ph_hi = ph + 1; hipLaunchKernelGGL(fwd, dim3(grid), dim3(512), LDS_BYTES, stream, a); }
#else
    a.ph_lo = 0; a.ph_hi = NPHASE;
    hipLaunchKernelGGL(fwd, dim3(grid), dim3(512), LDS_BYTES, stream, a);
#endif
    const hipError_t le = hipPeekAtLastError();
    if (le != hipSuccess) fprintf(stderr, "kernel_launch: launch failed: %s\n", hipGetErrorName(le));
}
```
